# Optimizing an MI355X kernel written in HIP

```python
import jax, jax.numpy as jnp
from jax import lax
import numpy as np

D_MODEL = 1024
BATCH = 4
SEQ = 4096
DEPTH = 1
DEC_BATCH = 32
DEC_SEQ = 32
PAST_LEN = 4096

CHUNK = 64
Q_BLOCK = 128
MIX_W = D_MODEL
LRU_W = MIX_W // 2
LRU_HEADS = 8
LRU_BLK = LRU_W // LRU_HEADS
CONV_W = 4
LRU_C = 8.0
MLA_HEADS = 8
QK_NOPE = 64
QK_ROPE = 32
V_DIM = 64
Q_LORA = D_MODEL // 4
KV_LORA = D_MODEL // 8
MLA_W = MLA_HEADS * V_DIM
IN_COLS = 2 * LRU_W + Q_LORA + KV_LORA + QK_ROPE
D_FF = 4 * D_MODEL
ROPE_BASE = 10000.0
EPS = 1e-6
ATTN_SCALE = (QK_NOPE + QK_ROPE) ** -0.5
NEG_INF = -1e30

kernel_name = "hymba_rglru_mla_streaming_step"


def rms_norm(x, g):
    xf = x.astype(jnp.float32)
    y = xf * lax.rsqrt(jnp.mean(xf * xf, axis=-1, keepdims=True) + EPS)
    return (y * g.astype(jnp.float32)).astype(x.dtype)


def rope_tables(pos):
    inv = ROPE_BASE ** (-jnp.arange(0, QK_ROPE, 2, dtype=jnp.float32) / QK_ROPE)
    ang = pos.astype(jnp.float32)[:, None] * inv[None, :]
    return jnp.cos(ang), jnp.sin(ang)


def apply_rope(x, cos, sin):
    xf = x.astype(jnp.float32)
    x1, x2 = jnp.split(xf, 2, axis=-1)
    out = jnp.concatenate([x1 * cos - x2 * sin, x2 * cos + x1 * sin], axis=-1)
    return out.astype(x.dtype)


def causal_conv(xb, buf, w, b):
    T = xb.shape[1]
    xp = jnp.concatenate([buf, xb], axis=1)
    y = b + sum(xp[:, k:k + T] * w[k] for k in range(CONV_W))
    return y, xp[:, -(CONV_W - 1):]


def rglru(xc, h0, w_a, b_a, w_i, b_i, lam):
    B, T, C = xc.shape
    xr = xc.reshape(B, T, LRU_HEADS, LRU_BLK)
    r = jax.nn.sigmoid(jnp.einsum('btnc,ncd->btnd', xr, w_a).reshape(B, T, C) + b_a)
    i = jax.nn.sigmoid(jnp.einsum('btnc,ncd->btnd', xr, w_i).reshape(B, T, C) + b_i)
    log_a = -LRU_C * r.astype(jnp.float32) * jax.nn.softplus(-lam.astype(jnp.float32))
    a = jnp.exp(log_a)
    bx = jnp.sqrt(-jnp.expm1(2.0 * log_a)) * (i * xc).astype(jnp.float32)

    def combine(lhs, rhs):
        a1, b1 = lhs
        a2, b2 = rhs
        return a1 * a2, a2 * b1 + b2

    a_cum, b_cum = lax.associative_scan(combine, (a, bx), axis=1)
    h = a_cum * h0.astype(jnp.float32)[:, None, :] + b_cum
    return h.astype(xc.dtype), h[:, -1].astype(h0.dtype)


def mla_attend(q_lat, q_rope, ckv, krope, mask):
    s = (jnp.einsum('bqhr,bkr->bhqk', q_lat, ckv).astype(jnp.float32)
         + jnp.einsum('bqhe,bke->bhqk', q_rope, krope).astype(jnp.float32)) * ATTN_SCALE
    if mask is not None:
        s = jnp.where(mask[None, None], s, NEG_INF)
    p = jax.nn.softmax(s, axis=-1).astype(ckv.dtype)
    return jnp.einsum('bhqk,bkr->bqhr', p, ckv)


def mla_prompt(q_lat, q_rope, ckv, krope):
    B, T, H, R = q_lat.shape
    n_blk = T // Q_BLOCK
    k_chunk = jnp.arange(ckv.shape[1]) // CHUNK

    def one_block(blk):
        start = blk * Q_BLOCK
        qs = lax.dynamic_slice_in_dim(q_lat, start, Q_BLOCK, axis=1)
        qr = lax.dynamic_slice_in_dim(q_rope, start, Q_BLOCK, axis=1)
        q_chunk = (start + jnp.arange(Q_BLOCK)) // CHUNK
        mask = k_chunk[None, :] <= q_chunk[:, None]
        return mla_attend(qs, qr, ckv, krope, mask)

    o = lax.map(one_block, jnp.arange(n_blk))
    return jnp.transpose(o, (1, 0, 2, 3, 4)).reshape(B, T, H, R)


def trunk_layer(x, pos, ckv_past, krope_past, h0, conv0, lw):
    (g_pre_mix, g_post_mix, g_pre_mlp, g_post_mlp, w_in, conv_w, conv_b,
     w_a, b_a, w_i, b_i, lam, g_q, w_uq, g_kv, w_ukv, w_out, w_up, w_down) = lw
    B, T, _ = x.shape
    xn = rms_norm(x, g_pre_mix)
    proj = jnp.einsum('btd,dc->btc', xn, w_in)
    x_lru, gate, c_q, c_kv, k_r = jnp.split(
        proj, [LRU_W, 2 * LRU_W, 2 * LRU_W + Q_LORA, 2 * LRU_W + Q_LORA + KV_LORA], axis=-1)

    xc, conv_new = causal_conv(x_lru, conv0, conv_w, conv_b)
    h, h_last = rglru(xc, h0, w_a, b_a, w_i, b_i, lam)
    y_lru = h * jax.nn.gelu(gate)

    cos, sin = rope_tables(pos)
    q = jnp.einsum('btr,rhe->bthe', rms_norm(c_q, g_q), w_uq)
    q_nope = q[..., :QK_NOPE]
    q_rope = apply_rope(q[..., QK_NOPE:], cos[:, None, :], sin[:, None, :])
    ckv_new = rms_norm(c_kv, g_kv)
    krope_new = apply_rope(k_r, cos, sin)
    w_uk = w_ukv[..., :QK_NOPE]
    w_uv = w_ukv[..., QK_NOPE:]
    q_lat = jnp.einsum('bthn,rhn->bthr', q_nope, w_uk)
    if ckv_past is None:
        o_lat = mla_prompt(q_lat, q_rope, ckv_new, krope_new)
    else:
        ckv_all = jnp.concatenate([ckv_past, ckv_new], axis=1)
        krope_all = jnp.concatenate([krope_past, krope_new], axis=1)
        o_lat = mla_attend(q_lat, q_rope, ckv_all, krope_all, None)
    o_mla = jnp.einsum('bthr,rhv->bthv', o_lat, w_uv).reshape(B, T, MLA_W)

    mix = jnp.einsum('btc,cd->btd', jnp.concatenate([y_lru, o_mla], axis=-1), w_out)
    x = x + rms_norm(mix, g_post_mix)

    hid = jax.nn.relu(jnp.einsum('btd,df->btf', rms_norm(x, g_pre_mlp), w_up))
    ff = jnp.einsum('btf,fd->btd', jnp.square(hid), w_down)
    x = x + rms_norm(ff, g_post_mlp)
    return x, ckv_new, krope_new, h_last, conv_new


def setup_inputs(seed: int = 0) -> dict:
    key = jax.random.key(seed)
    ks = jax.random.split(key, 32)
    f32 = jnp.float32

    def nrm(k, shape, scale):
        return jax.random.normal(k, shape, f32) * scale

    def gain(k, n):
        return 1.0 + 0.05 * jax.random.normal(k, (DEPTH, n), f32)

    a0 = jax.random.uniform(ks[31], (DEPTH, LRU_W), f32, 0.9, 0.999)
    return {
        "x_prompt": nrm(ks[0], (BATCH, SEQ, D_MODEL), 1.0),
        "x_sample": nrm(ks[1], (DEC_BATCH, DEC_SEQ, D_MODEL), 1.0),
        "cache_ckv": nrm(ks[2], (DEPTH, DEC_BATCH, PAST_LEN, KV_LORA), 1.0),
        "cache_krope": nrm(ks[3], (DEPTH, DEC_BATCH, PAST_LEN, QK_ROPE), 0.5),
        "state_lru_h": nrm(ks[4], (DEPTH, DEC_BATCH, LRU_W), 0.5),
        "state_conv": nrm(ks[5], (DEPTH, DEC_BATCH, CONV_W - 1, LRU_W), 0.5),
        "norm_pre_mix": gain(ks[6], D_MODEL),
        "norm_post_mix": gain(ks[7], D_MODEL),
        "norm_pre_mlp": gain(ks[8], D_MODEL),
        "norm_post_mlp": gain(ks[9], D_MODEL),
        "w_in": nrm(ks[10], (DEPTH, D_MODEL, IN_COLS), D_MODEL ** -0.5),
        "conv_w": nrm(ks[11], (DEPTH, CONV_W, LRU_W), 0.5),
        "conv_b": nrm(ks[12], (DEPTH, LRU_W), 0.02),
        "lru_w_a": nrm(ks[13], (DEPTH, LRU_HEADS, LRU_BLK, LRU_BLK), LRU_BLK ** -0.5),
        "lru_b_a": nrm(ks[14], (DEPTH, LRU_W), 0.02),
        "lru_w_i": nrm(ks[15], (DEPTH, LRU_HEADS, LRU_BLK, LRU_BLK), LRU_BLK ** -0.5),
        "lru_b_i": nrm(ks[16], (DEPTH, LRU_W), 0.02),
        "lru_lambda": jnp.log(a0) - jnp.log1p(-a0),
        "q_norm": gain(ks[17], Q_LORA),
        "w_uq": nrm(ks[18], (DEPTH, Q_LORA, MLA_HEADS, QK_NOPE + QK_ROPE), Q_LORA ** -0.5),
        "kv_norm": gain(ks[19], KV_LORA),
        "w_ukv": nrm(ks[20], (DEPTH, KV_LORA, MLA_HEADS, QK_NOPE + V_DIM), KV_LORA ** -0.5),
        "w_out": nrm(ks[21], (DEPTH, MIX_W, D_MODEL), MIX_W ** -0.5),
        "w_up": nrm(ks[22], (DEPTH, D_MODEL, D_FF), D_MODEL ** -0.5),
        "w_down": nrm(ks[23], (DEPTH, D_FF, D_MODEL), D_FF ** -0.5),
    }


def reference(x_prompt, x_sample, cache_ckv, cache_krope, state_lru_h, state_conv,
              norm_pre_mix, norm_post_mix, norm_pre_mlp, norm_post_mlp, w_in, conv_w, conv_b,
              lru_w_a, lru_b_a, lru_w_i, lru_b_i, lru_lambda, q_norm, w_uq, kv_norm, w_ukv,
              w_out, w_up, w_down):
    B, T_p, _ = x_prompt.shape
    T_s = x_sample.shape[1]
    pos_p = jnp.arange(T_p)
    pos_s = PAST_LEN + jnp.arange(T_s)
    h0_p = jnp.zeros((B, LRU_W), x_prompt.dtype)
    conv0_p = jnp.zeros((B, CONV_W - 1, LRU_W), x_prompt.dtype)

    y_p, y_s = x_prompt, x_sample
    st_p, st_s = [], []
    for l in range(DEPTH):
        lw = (norm_pre_mix[l], norm_post_mix[l], norm_pre_mlp[l], norm_post_mlp[l],
              w_in[l], conv_w[l], conv_b[l], lru_w_a[l], lru_b_a[l], lru_w_i[l], lru_b_i[l],
              lru_lambda[l], q_norm[l], w_uq[l], kv_norm[l], w_ukv[l], w_out[l], w_up[l], w_down[l])
        y_p, ckv_p, kr_p, h_p, cv_p = trunk_layer(y_p, pos_p, None, None, h0_p, conv0_p, lw)
        y_s, ckv_s, kr_s, h_s, cv_s = trunk_layer(y_s, pos_s, cache_ckv[l], cache_krope[l],
                                                  state_lru_h[l], state_conv[l], lw)
        st_p.append((ckv_p, kr_p, h_p, cv_p))
        st_s.append((ckv_s, kr_s, h_s, cv_s))

    new_ckv_p, new_kr_p, new_h_p, new_cv_p = [jnp.stack(a) for a in zip(*st_p)]
    new_ckv_s, new_kr_s, new_h_s, new_cv_s = [jnp.stack(a) for a in zip(*st_s)]
    return (y_p, y_s, new_ckv_p, new_kr_p, new_h_p, new_cv_p,
            new_ckv_s, new_kr_s, new_h_s, new_cv_s)
```

```cpp
#include <hip/hip_runtime.h>
#include <cstdio>
#include <cstdint>

__device__ __forceinline__ int fresh_tid() { int t = threadIdx.x; asm volatile("" : "+v"(t)); return t; }
namespace pg8 {
#define PG8_LAS __attribute__((address_space(3)))
typedef unsigned short bf16_t;
typedef short bf16x8 __attribute__((ext_vector_type(8)));
typedef float f32x4 __attribute__((ext_vector_type(4)));
typedef unsigned u32x4 __attribute__((ext_vector_type(4)));
constexpr int BM = 256, BK = 64, HALF = 128, HTB = HALF * BK * 2, STAGE_BYTES = 8 * HTB, NXCD = 8, WGM = 8;

__host__ __device__ __forceinline__ int lds_byte(int r, int c) { const int st = (r >> 4) * 2 + (c >> 5), rr = r & 15, cc = c & 31, ob = rr * 64 + cc * 2; return st * 1024 + (ob ^ (((ob >> 9) & 1) << 5)); }
__host__ __device__ __forceinline__ void stage_rc(int b, int& R, int& C) { const int st = b / 1024, sb = b % 1024, swz = sb ^ (((sb >> 9) & 1) << 5); R = (st >> 1) * 16 + swz / 64; C = (st & 1) * 32 + (swz % 64) / 2; }
__host__ __device__ __forceinline__ int perm32(int rho) { const int n = rho >> 4, i = rho & 15; return 8 * (i >> 2) + 4 * n + (i & 3); }

struct Unit { int pm, pn; };
struct Gemm { const bf16_t* A; const bf16_t* Bt; int M, N, K, lda; };

struct StaticOrder {
    int nM, nN, nwg, G, c;
    __host__ __device__ void init(int M, int N, int G_, int c_) { nM = M / BM; nN = N / BM; nwg = nM * nN; G = G_; c = c_; }
    __host__ __device__ bool next(int i, Unit& u) const {
        const long L = (long)i * G + c; if (L >= nwg) return false;
        int wgid = (int)L; { const int q = nwg / NXCD, r = nwg % NXCD, xcd = wgid % NXCD, off = wgid / NXCD; wgid = (xcd < r ? xcd * (q + 1) : r * (q + 1) + (xcd - r) * q) + off; }
        const int nig = WGM * nN, gid = wgid / nig, fm = gid * WGM, gsz = (nM - fm) < WGM ? (nM - fm) : WGM;
        u.pm = fm + ((wgid % nig) % gsz); u.pn = (wgid % nig) / gsz; return true;
    }
    __device__ __forceinline__ void a_ready(const Unit&) const {}
    __device__ __forceinline__ void done(const Unit&) const {}
};

__device__ __forceinline__ unsigned cvt_pk_bf16(float lo, float hi) { unsigned r; asm volatile("v_cvt_pk_bf16_f32 %0, %1, %2" : "=v"(r) : "v"(lo), "v"(hi)); return r; }

struct EpiF32 {
    static constexpr bool PERM = false, AFTER_DRAIN = false;
    float* C; int ldc;
    __device__ __forceinline__ void operator()(const f32x4 (&acc)[2][2][4][2], const Unit& u, int wr, int wc, int fr, int fq) const {
        const int row0 = u.pm * BM + wr * 64 + fr, col0 = u.pn * BM + wc * 32 + 4 * fq;
#pragma unroll
        for (int ai = 0; ai < 2; ++ai)
#pragma unroll
            for (int m = 0; m < 4; ++m) { float* rowp = C + (size_t)(row0 + ai * HALF + m * 16) * ldc + col0;
#pragma unroll
                for (int bj = 0; bj < 2; ++bj)
#pragma unroll
                    for (int n = 0; n < 2; ++n) *(f32x4*)(rowp + bj * HALF + n * 16) = acc[ai][bj][m][n]; }
    }
};
template <int ACT  > struct EpiBf16 {
    static constexpr bool PERM = true, AFTER_DRAIN = false;
    bf16_t* O; int ldc;
    __device__ __forceinline__ void operator()(const f32x4 (&acc)[2][2][4][2], const Unit& u, int wr, int wc, int fr, int fq) const {
        const int row0 = u.pm * BM + wr * 64 + fr; const int col0 = u.pn * BM + wc * 32 + 8 * fq;
#pragma unroll
        for (int ai = 0; ai < 2; ++ai)
#pragma unroll
            for (int m = 0; m < 4; ++m) { bf16_t* rowp = O + (size_t)(row0 + ai * HALF + m * 16) * ldc + col0;
#pragma unroll
                for (int bj = 0; bj < 2; ++bj) { f32x4 v0 = acc[ai][bj][m][0], v1 = acc[ai][bj][m][1];
                    if (ACT == 2) {
#pragma unroll
                        for (int e = 0; e < 4; ++e) { const float a = fmaxf(v0[e], 0.f), b = fmaxf(v1[e], 0.f); v0[e] = a * a; v1[e] = b * b; } }
                    u32x4 w; w.x = cvt_pk_bf16(v0[0], v0[1]); w.y = cvt_pk_bf16(v0[2], v0[3]); w.z = cvt_pk_bf16(v1[0], v1[1]); w.w = cvt_pk_bf16(v1[2], v1[3]);
                    *(u32x4*)(rowp + bj * HALF) = w; } }
    }
};

template <class Epi, class Sched, bool ALIGN_EPI = false, bool SP2 = false>
__device__ __forceinline__ void gemm_phase(PG8_LAS unsigned char* lds, const Gemm g, const Sched& S, const Epi& E) {
    const int tid = fresh_tid(), wid = __builtin_amdgcn_readfirstlane(tid >> 6), lane = tid & 63, wr = wid >> 2, wc = wid & 3, fr = lane & 15, fq = lane >> 4;
    const int K = g.K, nt = K / BK, lda = g.lda;
    unsigned voffA[2], voffB[2];
#pragma unroll
    for (int i = 0; i < 2; ++i) { int R, C; stage_rc(tid * 16 + i * 8192, R, C); const int Rb = Epi::PERM ? ((R & ~31) + perm32(R & 31)) : R;
        voffA[i] = (unsigned)(R * lda + C) * 2u; voffB[i] = (unsigned)(Rb * K + C) * 2u; }
    const size_t kstep = (size_t)(BK * 2);
    const size_t hstepA = (size_t)HALF * lda * 2, hstepB = (size_t)HALF * K * 2;
    const size_t tstepA = 2 * hstepA, tstepB = 2 * hstepB;
    const unsigned ldsw = (unsigned)wid * 1024u;
    const int aoff = lds_byte(wr * 64 + fr, fq * 8), boff = lds_byte(wc * 32 + fr, fq * 8);
#define PG8_SA(b, h) (((b) * 2 + (h)) * HTB)
#define PG8_SB(b, h) ((4 + (b) * 2 + (h)) * HTB)
#define PG8_STAGE(bufoff, gbase, voff) do { _Pragma("unroll") for (int _i = 0; _i < 2; ++_i) \
        __builtin_amdgcn_global_load_lds((const unsigned*)((const char*)(gbase) + (voff)[_i]), (PG8_LAS unsigned*)(lds + (bufoff) + ldsw + _i * 8192), 16, 0, 0); } while (0)
#define PG8_LDA(dst, b, h) do { _Pragma("unroll") for (int m = 0; m < 4; ++m) _Pragma("unroll") for (int k = 0; k < 2; ++k) dst[m][k] = *(const PG8_LAS bf16x8*)(lds + PG8_SA(b, h) + aoff + m * 2048 + k * 1024); } while (0)
#define PG8_LDB(dst, b, h) do { _Pragma("unroll") for (int n = 0; n < 2; ++n) _Pragma("unroll") for (int k = 0; k < 2; ++k) dst[n][k] = *(const PG8_LAS bf16x8*)(lds + PG8_SB(b, h) + boff + n * 2048 + k * 1024); } while (0)
#define PG8_MMA(ai, bj, At, Bt) do { __builtin_amdgcn_s_setprio(1); _Pragma("unroll") for (int m = 0; m < 4; ++m) _Pragma("unroll") for (int n = 0; n < 2; ++n) _Pragma("unroll") for (int k = 0; k < 2; ++k) \
        acc[ai][bj][m][n] = __builtin_amdgcn_mfma_f32_16x16x32_bf16(Bt[n][k], At[m][k], acc[ai][bj][m][n], 0, 0, 0); __builtin_amdgcn_s_setprio(0); } while (0)
#define PG8_WAIT_V(n) asm volatile("s_waitcnt vmcnt(" #n ")" ::: "memory")
#define PG8_WAIT_L(n) asm volatile("s_waitcnt lgkmcnt(" #n ")" ::: "memory")
#define PG8_BAR __builtin_amdgcn_s_barrier()
#define PG8_SCHED __builtin_amdgcn_sched_barrier(0)
    Unit cur, nxt; int ui = 0;
    if (!S.next(0, cur)) return;
    f32x4 acc[2][2][4][2];
#pragma unroll
    for (int a = 0; a < 2; ++a)
#pragma unroll
        for (int b = 0; b < 2; ++b)
#pragma unroll
            for (int m = 0; m < 4; ++m)
#pragma unroll
                for (int n = 0; n < 2; ++n) acc[a][b][m][n] = (f32x4){0.f, 0.f, 0.f, 0.f};
    bf16x8 At[4][2], B0[2][2], B1[2][2];
    const char* cA = (const char*)g.A + (size_t)cur.pm * tstepA; const char* cB = (const char*)g.Bt + (size_t)cur.pn * tstepB;
    S.a_ready(cur);
    if constexpr (SP2) {
        PG8_STAGE(PG8_SB(0, 0), cB, voffB); PG8_STAGE(PG8_SB(0, 1), cB + hstepB, voffB); PG8_STAGE(PG8_SA(0, 0), cA, voffA); PG8_STAGE(PG8_SA(0, 1), cA + hstepA, voffA);
        if (wr == 1) PG8_BAR;
        PG8_WAIT_V(2); PG8_BAR;
        PG8_STAGE(PG8_SB(1, 0), cB + kstep, voffB); PG8_STAGE(PG8_SA(1, 0), cA + kstep, voffA); PG8_STAGE(PG8_SB(1, 1), cB + hstepB + kstep, voffB);
        PG8_WAIT_V(6); PG8_BAR;
    } else {
        PG8_STAGE(PG8_SB(0, 0), cB, voffB); PG8_STAGE(PG8_SA(0, 0), cA, voffA); PG8_STAGE(PG8_SB(0, 1), cB + hstepB, voffB); PG8_STAGE(PG8_SA(0, 1), cA + hstepA, voffA);
        if (wr == 1) PG8_BAR;
        PG8_WAIT_V(4); PG8_BAR;
        PG8_STAGE(PG8_SB(1, 0), cB + kstep, voffB); PG8_STAGE(PG8_SA(1, 0), cA + kstep, voffA); PG8_STAGE(PG8_SB(1, 1), cB + hstepB + kstep, voffB);
        PG8_WAIT_V(6); PG8_BAR;
    }
    for (;;) {
        const bool has_next = S.next(ui + 1, nxt);
        const char* nA = has_next ? (const char*)g.A + (size_t)nxt.pm * tstepA : cA; const char* nB = has_next ? (const char*)g.Bt + (size_t)nxt.pn * tstepB : cB;
        for (int t = 0; t < nt; t += 2) {
            const bool last = (t == nt - 2);
            const char* a1 = cA + (size_t)(t + 1) * kstep;
            const char* a2 = last ? nA : cA + (size_t)(t + 2) * kstep; const char* b2 = last ? nB : cB + (size_t)(t + 2) * kstep;
            const char* a3 = a2 + kstep; const char* b3 = b2 + kstep;
            if (last && has_next) S.a_ready(nxt);
            if constexpr (SP2) {
            PG8_LDB(B0, 0, 0); PG8_LDB(B1, 0, 1); PG8_SCHED; PG8_LDA(At, 0, 0); PG8_STAGE(PG8_SA(1, 1), a1 + hstepA, voffA);
            PG8_WAIT_V(8); PG8_WAIT_L(0); PG8_BAR; PG8_MMA(0, 0, At, B0); PG8_MMA(0, 1, At, B1); PG8_BAR; PG8_SCHED;
            PG8_LDA(At, 0, 1); PG8_STAGE(PG8_SB(0, 0), b2, voffB); PG8_STAGE(PG8_SB(0, 1), b2 + hstepB, voffB); PG8_STAGE(PG8_SA(0, 0), a2, voffA);
            PG8_WAIT_V(8); PG8_WAIT_L(0); PG8_BAR; PG8_MMA(1, 0, At, B0); PG8_MMA(1, 1, At, B1); PG8_BAR; PG8_SCHED;
            PG8_LDB(B0, 1, 0); PG8_LDB(B1, 1, 1); PG8_SCHED; PG8_LDA(At, 1, 0); PG8_STAGE(PG8_SA(0, 1), a2 + hstepA, voffA);
            PG8_WAIT_V(8); PG8_WAIT_L(0); PG8_BAR; PG8_MMA(0, 0, At, B0); PG8_MMA(0, 1, At, B1); PG8_BAR; PG8_SCHED;
            PG8_LDA(At, 1, 1); PG8_STAGE(PG8_SB(1, 0), b3, voffB); PG8_STAGE(PG8_SB(1, 1), b3 + hstepB, voffB); PG8_STAGE(PG8_SA(1, 0), a3, voffA);
            PG8_WAIT_V(8); PG8_WAIT_L(0); PG8_BAR; PG8_MMA(1, 0, At, B0); PG8_MMA(1, 1, At, B1); PG8_BAR; PG8_SCHED;
            } else {
            PG8_LDB(B0, 0, 0); PG8_SCHED; PG8_LDA(At, 0, 0); PG8_STAGE(PG8_SA(1, 1), a1 + hstepA, voffA);
            PG8_WAIT_L(8); PG8_BAR; PG8_WAIT_L(0); PG8_MMA(0, 0, At, B0); PG8_BAR; PG8_SCHED;
            PG8_LDB(B1, 0, 1); PG8_STAGE(PG8_SB(0, 0), b2, voffB);
            PG8_BAR; PG8_WAIT_L(0); PG8_MMA(0, 1, At, B1); PG8_BAR;
            PG8_LDA(At, 0, 1); PG8_STAGE(PG8_SA(0, 0), a2, voffA);
            PG8_BAR; PG8_WAIT_L(0); PG8_MMA(1, 0, At, B0); PG8_BAR; PG8_SCHED;
            PG8_STAGE(PG8_SB(0, 1), b2 + hstepB, voffB);
            PG8_WAIT_V(6); PG8_BAR; PG8_MMA(1, 1, At, B1); PG8_BAR;
            PG8_LDB(B0, 1, 0); PG8_SCHED; PG8_LDA(At, 1, 0); PG8_STAGE(PG8_SA(0, 1), a2 + hstepA, voffA);
            PG8_WAIT_L(8); PG8_BAR; PG8_WAIT_L(0); PG8_MMA(0, 0, At, B0); PG8_BAR; PG8_SCHED;
            PG8_LDB(B1, 1, 1); PG8_STAGE(PG8_SB(1, 0), b3, voffB);
            PG8_BAR; PG8_WAIT_L(0); PG8_MMA(0, 1, At, B1); PG8_BAR;
            PG8_LDA(At, 1, 1); PG8_STAGE(PG8_SA(1, 0), a3, voffA);
            PG8_BAR; PG8_WAIT_L(0); PG8_MMA(1, 0, At, B0); PG8_BAR; PG8_SCHED;
            PG8_STAGE(PG8_SB(1, 1), b3 + hstepB, voffB);
            PG8_WAIT_V(6); PG8_BAR; PG8_MMA(1, 1, At, B1); PG8_BAR;
            }
        }
        if constexpr (ALIGN_EPI) { if (wr == 0) PG8_BAR; }
        if constexpr (!Epi::AFTER_DRAIN) { E(acc, cur, wr, wc, fr, fq); S.done(cur); }
        if (!has_next) break;
#pragma unroll
        for (int a = 0; a < 2; ++a)
#pragma unroll
            for (int b = 0; b < 2; ++b)
#pragma unroll
                for (int m = 0; m < 4; ++m)
#pragma unroll
                    for (int n = 0; n < 2; ++n) acc[a][b][m][n] = (f32x4){0.f, 0.f, 0.f, 0.f};
        cur = nxt; cA = nA; cB = nB; ++ui;
        if constexpr (ALIGN_EPI) { if (wr == 1) PG8_BAR; }
    }
    PG8_WAIT_V(0);
    if constexpr (!ALIGN_EPI) { if (wr == 0) PG8_BAR; }
    PG8_BAR;
    if constexpr (Epi::AFTER_DRAIN) { E.fused(acc, cur, wr, wc, fr, fq, lds, wid, lane); S.done(cur); }
#undef PG8_SA
#undef PG8_SB
#undef PG8_STAGE
#undef PG8_LDA
#undef PG8_LDB
#undef PG8_MMA
#undef PG8_WAIT_V
#undef PG8_WAIT_L
#undef PG8_BAR
#undef PG8_SCHED
}
}

constexpr int D = 1024, NB = 4, SEQ = 4096, DB = 32, DS = 32, PAST = 4096;
constexpr int MP = NB * SEQ, MS = DB * DS, M = MP + MS;
constexpr int LRU_W = 512, QL = 256, KVL = 128, ROPE = 32, NH = 8, NOPE = 64, VD = 64, FF = 4096;
constexpr int INC = 1440, INP = 1536;
constexpr int QN = 1280;
constexpr int KVD = 160;
constexpr int KMIX = 1536;
constexpr int SKV = PAST + DS, SKVP = 4160;
constexpr float EPS = 1e-6f;
constexpr float QSCALE = 0.10206207261596575f * 1.4426950408889634f;

constexpr size_t MiB = 1u << 20;
constexpr size_t WS_CTL = 0, CTL_ZERO_BYTES = 1 * MiB;
constexpr size_t WS_W1 = 1 * MiB, WS_WQ = 4 * MiB, WS_WO = 5 * MiB, WS_WUP = 8 * MiB, WS_WDN = 16 * MiB;
constexpr size_t WS_ROPE = 24 * MiB, WS_RSTDQ = 25 * MiB, WS_AGG = 25 * MiB + 512 * 1024;
constexpr size_t WS_XN2 = 28 * MiB;
constexpr size_t WS_XN = 64 * MiB;
constexpr size_t WS_PROJ = 107 * MiB;
constexpr size_t WS_KVP = 158 * MiB;
constexpr size_t WS_KVS = 163 * MiB;
constexpr size_t WS_MIX = 204 * MiB;
constexpr size_t WS_HID = 64 * MiB;
constexpr size_t WS_END = 255 * MiB;
constexpr size_t O_Y = 0, O_CKVP = (size_t)M * D, O_KRP = O_CKVP + (size_t)MP * KVL, O_HP = O_KRP + (size_t)MP * ROPE, O_CVP = O_HP + NB * LRU_W,
                 O_CKVS = O_CVP + NB * 3 * LRU_W, O_KRS = O_CKVS + (size_t)MS * KVL, O_HS = O_KRS + (size_t)MS * ROPE, O_CVS = O_HS + DB * LRU_W, O_END = O_CVS + DB * 3 * LRU_W;
constexpr int CW_TMO = 0, CW_CODE = 1, CW_QUEUE = 64, CW_BAR = 4096, CW_AGGF = 16384;

constexpr int RING_BYTES = 131072, LDSCTL_OFF = RING_BYTES, MISC_OFF = LDSCTL_OFF + 320, LDS_BYTES = 147456;
constexpr int NWAVES = 8;

#define GAS __attribute__((address_space(1)))
#define LAS __attribute__((address_space(3)))
typedef unsigned short bf16;
typedef unsigned v4u __attribute__((ext_vector_type(4)));
typedef unsigned v2u __attribute__((ext_vector_type(2)));
typedef float f32x4 __attribute__((ext_vector_type(4)));
typedef float f32x16 __attribute__((ext_vector_type(16)));
typedef short bf16x8 __attribute__((ext_vector_type(8)));
typedef short s16x4 __attribute__((ext_vector_type(4)));
typedef GAS unsigned gu32;
#define RLX_AGENT __ATOMIC_RELAXED, __HIP_MEMORY_SCOPE_AGENT
#define LDS_WAIT() asm volatile("s_waitcnt lgkmcnt(0)" ::: "memory")
#define VM_WAIT() asm volatile("s_waitcnt vmcnt(0)" ::: "memory")
#define SBAR() __builtin_amdgcn_sched_barrier(0)
__device__ __forceinline__ unsigned f2bf(float f) { unsigned u = __builtin_bit_cast(unsigned, f); return (u + 0x7fffu + ((u >> 16) & 1u)) >> 16; }
__device__ __forceinline__ unsigned pk2(float lo, float hi) { return f2bf(lo) | (f2bf(hi) << 16); }
__device__ __forceinline__ float bf2f(unsigned short b) { return __builtin_bit_cast(float, (unsigned)b << 16); }
__device__ __forceinline__ float bflo(unsigned w) { return __builtin_bit_cast(float, w << 16); }
__device__ __forceinline__ float bfhi(unsigned w) { return __builtin_bit_cast(float, w & 0xffff0000u); }
__device__ __forceinline__ unsigned cvtpk(float lo, float hi) { unsigned r; asm volatile("v_cvt_pk_bf16_f32 %0, %1, %2" : "=v"(r) : "v"(lo), "v"(hi)); return r; }
__device__ __forceinline__ float wave_sum(float v) {
#pragma unroll
    for (int o = 1; o < 64; o <<= 1) v += __shfl_xor(v, o);
    return v;
}
__device__ __forceinline__ int crow(int r, int hi) { return (r & 3) + 8 * (r >> 2) + 4 * hi; }

#define XB_TMO      128
#define XB_XCNT(j)  (256  + 64 * (j))
#define XB_XSUB(j)  (1280 + 64 * (j))
#define XB_XGEN(j)  (2304 + 64 * (j))
#define XB_TOP      3328
#define XB_TOPGEN   3392
#define XCD_BAR_WORDS 3456
#define XB_SPIN_CAP (1u << 18)
__device__ __forceinline__ unsigned xb_ld(unsigned* p)              { return __hip_atomic_load(p, __ATOMIC_RELAXED, __HIP_MEMORY_SCOPE_AGENT); }
__device__ __forceinline__ unsigned xb_add(unsigned* p, unsigned v) { return __hip_atomic_fetch_add(p, v, __ATOMIC_RELAXED, __HIP_MEMORY_SCOPE_AGENT); }
__device__ __forceinline__ unsigned xb_xcc_id() { return (unsigned)__builtin_amdgcn_s_getreg((3 << 11) | 20) & 0xFu; }
#define XB_SPIN(cond, bar) do { unsigned _sp = 0; while (cond) { __builtin_amdgcn_s_sleep(1); \
    if ((++_sp & 255u) == 0u) { if (xb_ld(&(bar)[XB_TMO])) break; if (_sp > XB_SPIN_CAP) { atomicAdd(&(bar)[XB_TMO], 1u); break; } } } } while (0)
struct XcdBarrier { unsigned* bar; unsigned x; volatile LAS unsigned* st; };
__device__ __forceinline__ XcdBarrier xcd_barrier_post(unsigned* bar, volatile LAS unsigned* st) {
    XcdBarrier b; b.bar = bar; b.x = xb_xcc_id(); b.st = st;
    if (threadIdx.x == 0) (void)xb_add(&bar[XB_XCNT(b.x)], 1u);
    return b;
}
__device__ __forceinline__ void xcd_barrier_complete(unsigned* bar, unsigned x, unsigned& nloc, unsigned& nx) {
    const unsigned G = gridDim.x * gridDim.y * gridDim.z;
    unsigned sum, cnt, mine, sp = 0u;
    for (;;) {
        sum = 0u; cnt = 0u; mine = 0u;
#pragma unroll
        for (unsigned j = 0; j < 16; ++j) { const unsigned c = xb_ld(&bar[XB_XCNT(j)]); sum += c; cnt += (c > 0u) ? 1u : 0u; mine = (j == x) ? c : mine; }
        if (sum == G) break;
        __builtin_amdgcn_s_sleep(1);
        if ((++sp & 255u) == 0u) { if (xb_ld(&bar[XB_TMO])) break; if (sp > XB_SPIN_CAP) { atomicAdd(&bar[XB_TMO], 1u); break; } }
    }
    nloc = mine > 0u ? mine : 1u; nx = cnt > 0u ? cnt : 1u;
}
__device__ __forceinline__ void xcd_barrier(const XcdBarrier& b) {
    asm volatile("s_waitcnt vmcnt(0)" ::: "memory");
    __syncthreads();
    if (threadIdx.x == 0) {
        unsigned* bar = b.bar;
        __builtin_amdgcn_s_waitcnt(0);
        unsigned nloc = b.st[0], nx = b.st[1];
        if (nloc == 0u) { xcd_barrier_complete(bar, b.x, nloc, nx); b.st[0] = nloc; b.st[1] = nx; }
        const unsigned old = xb_add(&bar[XB_XSUB(b.x)], 1u);
        const unsigned gen = old / nloc;
        if (old + 1u == (gen + 1u) * nloc) {
            __builtin_amdgcn_fence(__ATOMIC_RELEASE, "agent");
            asm volatile("s_waitcnt vmcnt(0)" ::: "memory");
            const unsigned og = xb_add(&bar[XB_TOP], 1u);
            const unsigned tg = og / nx;
            if (og + 1u == (tg + 1u) * nx) xb_add(&bar[XB_TOPGEN], 1u);
            else XB_SPIN(xb_ld(&bar[XB_TOPGEN]) == tg, bar);
            __builtin_amdgcn_fence(__ATOMIC_ACQUIRE, "agent");
            xb_add(&bar[XB_XGEN(b.x)], 1u);
            asm volatile("s_waitcnt vmcnt(0)" ::: "memory");
        } else {
            XB_SPIN(xb_ld(&bar[XB_XGEN(b.x)]) == gen, bar);
            __builtin_amdgcn_fence(__ATOMIC_ACQUIRE, "agent");
            asm volatile("s_waitcnt vmcnt(0)" ::: "memory");
        }
    }
    __syncthreads();
}

struct Args { const float* in[25]; float* out; unsigned char* ws; };

__device__ __forceinline__ const float* xrow_ptr(const Args& a, int r) { return r < MP ? a.in[0] + (size_t)r * D : a.in[1] + (size_t)(r - MP) * D; }

__device__ __forceinline__ void p0_transpose_item(const float* W, int K, int N, int ldw, bf16* WT, int row_off, const float* gain, LAS float* scr, int item, int lane) {
    const int nblk = N / 32, kb = item / nblk, nb = item % nblk, k0 = 64 * kb, n0 = 32 * nb;
#pragma unroll 8
    for (int i = 0; i < 32; ++i) { const int kk = 2 * i + (lane >> 5); const float gk = gain ? gain[k0 + kk] : 1.f; scr[kk * 33 + (lane & 31)] = gk * W[(size_t)(k0 + kk) * ldw + n0 + (lane & 31)]; }
    LDS_WAIT(); asm volatile("" ::: "memory");
    const int c = lane & 7;
#pragma unroll
    for (int j = 0; j < 4; ++j) { const int n = (lane >> 3) + 8 * j; const LAS float* s = scr + (8 * c) * 33 + n;
        v4u o; o.x = pk2(s[0 * 33], s[1 * 33]); o.y = pk2(s[2 * 33], s[3 * 33]); o.z = pk2(s[4 * 33], s[5 * 33]); o.w = pk2(s[6 * 33], s[7 * 33]);
        *(GAS v4u*)(WT + (size_t)(row_off + n0 + n) * K + k0 + 8 * c) = o; }
    LDS_WAIT(); asm volatile("" ::: "memory");
}

constexpr int KROW = 336;
constexpr int KTILE = 64 * KROW;
constexpr int ATT_AL = 2 * KTILE;
template <int OFF> __device__ __forceinline__ s16x4 tr_read(int vb) {
    s16x4 r; asm volatile("ds_read_b64_tr_b16 %0, %1 offset:%2" : "=&v"(r) : "v"(vb), "i"(OFF) : "memory"); return r;
}
template <int D0> __device__ __forceinline__ void pv_one(f32x16& od, int vb, bf16x8 pa0, bf16x8 pa1, bf16x8 pa2, bf16x8 pa3) {
    const s16x4 l0 = tr_read<(0 * 16 + 0) * KROW + D0 * 64>(vb), h0 = tr_read<(0 * 16 + 4) * KROW + D0 * 64>(vb);
    const s16x4 l1 = tr_read<(1 * 16 + 0) * KROW + D0 * 64>(vb), h1 = tr_read<(1 * 16 + 4) * KROW + D0 * 64>(vb);
    const s16x4 l2 = tr_read<(2 * 16 + 0) * KROW + D0 * 64>(vb), h2 = tr_read<(2 * 16 + 4) * KROW + D0 * 64>(vb);
    const s16x4 l3 = tr_read<(3 * 16 + 0) * KROW + D0 * 64>(vb), h3 = tr_read<(3 * 16 + 4) * KROW + D0 * 64>(vb);
    asm volatile("s_waitcnt lgkmcnt(0)" ::: "memory"); SBAR();
#define PK(L, H) (bf16x8){L[0], L[1], L[2], L[3], H[0], H[1], H[2], H[3]}
    od = __builtin_amdgcn_mfma_f32_32x32x16_bf16(pa0, PK(l0, h0), od, 0, 0, 0);
    od = __builtin_amdgcn_mfma_f32_32x32x16_bf16(pa1, PK(l1, h1), od, 0, 0, 0);
    od = __builtin_amdgcn_mfma_f32_32x32x16_bf16(pa2, PK(l2, h2), od, 0, 0, 0);
    od = __builtin_amdgcn_mfma_f32_32x32x16_bf16(pa3, PK(l3, h3), od, 0, 0, 0);
#undef PK
}

__device__ __forceinline__ void attn_unit(const bf16* __restrict__ kv, int NT, bool mask_last, int qrow0, int pos0,
                                          const bf16* __restrict__ QRAW, const float* __restrict__ RSTDQ, const float* __restrict__ ROPET, bf16* __restrict__ MIX,
                                          char* lds) {
    const int tid = fresh_tid(), lane = tid & 63, r32 = lane & 31, hi = lane >> 5;
    const int wid = __builtin_amdgcn_readfirstlane(tid >> 6);
    float* al_l = (float*)(lds + ATT_AL) + wid * 64;
    int srow[3], sch[3];
#pragma unroll
    for (int i = 0; i < 3; ++i) { const int c = tid + 512 * i; srow[i] = c / 20; sch[i] = c % 20; }
    const bool has3 = (tid + 1024) < 1280;
    v4u st[3];
#define ALOAD(t) do { _Pragma("unroll") for (int i = 0; i < 3; ++i) if (i < 2 || has3) st[i] = *(const v4u*)(kv + (size_t)((t) * 64 + srow[i]) * KVD + sch[i] * 8); } while (0)
#define AWRITE(b) do { _Pragma("unroll") for (int i = 0; i < 3; ++i) if (i < 2 || has3) *(v4u*)(lds + (b) * KTILE + srow[i] * KROW + sch[i] * 16) = st[i]; } while (0)
    ALOAD(0);
    bf16x8 qr[10];
    {
        const int row = qrow0 + r32; const float rs = RSTDQ[row];
        const bf16* qp = QRAW + (size_t)row * QN + wid * 128 + hi * 8;
#pragma unroll
        for (int d0 = 0; d0 < 8; ++d0) { const v4u w = *(const v4u*)(qp + d0 * 16);
            v4u o; o.x = cvtpk(bflo(w.x) * rs, bfhi(w.x) * rs); o.y = cvtpk(bflo(w.y) * rs, bfhi(w.y) * rs); o.z = cvtpk(bflo(w.z) * rs, bfhi(w.z) * rs); o.w = cvtpk(bflo(w.w) * rs, bfhi(w.w) * rs);
            qr[d0] = __builtin_bit_cast(bf16x8, o); }
        const bf16* rp = QRAW + (size_t)row * QN + 1024 + wid * 32 + hi * 8;
        const v4u x1 = *(const v4u*)(rp), x2 = *(const v4u*)(rp + 16);
        const float* ct = ROPET + (size_t)(pos0 + r32) * 32 + hi * 8;
        const f32x4 c0 = *(const f32x4*)(ct), c1 = *(const f32x4*)(ct + 4), s0 = *(const f32x4*)(ct + 16), s1 = *(const f32x4*)(ct + 20);
        float a[8], b[8], c[8], s[8];
        a[0] = bflo(x1.x); a[1] = bfhi(x1.x); a[2] = bflo(x1.y); a[3] = bfhi(x1.y); a[4] = bflo(x1.z); a[5] = bfhi(x1.z); a[6] = bflo(x1.w); a[7] = bfhi(x1.w);
        b[0] = bflo(x2.x); b[1] = bfhi(x2.x); b[2] = bflo(x2.y); b[3] = bfhi(x2.y); b[4] = bflo(x2.z); b[5] = bfhi(x2.z); b[6] = bflo(x2.w); b[7] = bfhi(x2.w);
#pragma unroll
        for (int e = 0; e < 4; ++e) { c[e] = c0[e]; c[4 + e] = c1[e]; s[e] = s0[e]; s[4 + e] = s1[e]; }
        float o1[8], o2[8];
#pragma unroll
        for (int e = 0; e < 8; ++e) { o1[e] = (a[e] * c[e] - b[e] * s[e]) * rs; o2[e] = (b[e] * c[e] + a[e] * s[e]) * rs; }
        v4u w1, w2; w1.x = cvtpk(o1[0], o1[1]); w1.y = cvtpk(o1[2], o1[3]); w1.z = cvtpk(o1[4], o1[5]); w1.w = cvtpk(o1[6], o1[7]);
        w2.x = cvtpk(o2[0], o2[1]); w2.y = cvtpk(o2[2], o2[3]); w2.z = cvtpk(o2[4], o2[5]); w2.w = cvtpk(o2[6], o2[7]);
        qr[8] = __builtin_bit_cast(bf16x8, w1); qr[9] = __builtin_bit_cast(bf16x8, w2);
    }
    float m_reg = -1e30f, l_reg = 0.f; f32x16 o[4] = {};
    const int vbase = (int)(uintptr_t)lds + ((lane >> 5) * 8 + ((lane & 15) >> 2)) * KROW + (16 * ((lane >> 4) & 1) + 4 * (lane & 3)) * 2;
    AWRITE(0);
    __syncthreads();
    for (int j = 0; j < NT; ++j) {
        const int buf = j & 1;
        if (j + 1 < NT) ALOAD(j + 1);
        f32x16 p0 = {}, p1 = {};
        {
            const char* kb = lds + buf * KTILE + r32 * KROW + hi * 16;
            bf16x8 kA[2][2], kB[2][2];
#define KLD(dst, g) do { _Pragma("unroll") for (int e = 0; e < 2; ++e) { dst[e][0] = *(const bf16x8*)(kb + (2 * (g) + e) * 32); dst[e][1] = *(const bf16x8*)(kb + 32 * KROW + (2 * (g) + e) * 32); } } while (0)
#define KMM(src, g) do { _Pragma("unroll") for (int e = 0; e < 2; ++e) { p0 = __builtin_amdgcn_mfma_f32_32x32x16_bf16(src[e][0], qr[2 * (g) + e], p0, 0, 0, 0); p1 = __builtin_amdgcn_mfma_f32_32x32x16_bf16(src[e][1], qr[2 * (g) + e], p1, 0, 0, 0); } } while (0)
            KLD(kA, 0); SBAR();
            KLD(kB, 1); KMM(kA, 0); SBAR();
            KLD(kA, 2); KMM(kB, 1); SBAR();
            KLD(kB, 3); KMM(kA, 2); SBAR();
            KLD(kA, 4); KMM(kB, 3); SBAR();
            KMM(kA, 4); SBAR();
#undef KLD
#undef KMM
        }
        if (mask_last && j == NT - 1) {
#pragma unroll
            for (int r = 0; r < 16; ++r) p1[r] = -1e30f;
        }
        float pmax = p0[0];
#pragma unroll
        for (int r = 1; r < 16; ++r) pmax = fmaxf(pmax, p0[r]);
#pragma unroll
        for (int r = 0; r < 16; ++r) pmax = fmaxf(pmax, p1[r]);
        { auto rr = __builtin_amdgcn_permlane32_swap(__float_as_uint(pmax), __float_as_uint(pmax), false, false);
          pmax = fmaxf(__uint_as_float(rr[0]), __uint_as_float(rr[1])); }
        const float mn = fmaxf(m_reg, pmax);
        const float alpha = __builtin_amdgcn_exp2f(m_reg - mn);
        m_reg = mn;
#pragma unroll
        for (int r = 0; r < 16; ++r) { p0[r] = __builtin_amdgcn_exp2f(p0[r] - mn); p1[r] = __builtin_amdgcn_exp2f(p1[r] - mn); }
        float ps = 0.f;
#pragma unroll
        for (int r = 0; r < 16; ++r) ps += p0[r] + p1[r];
        { auto rr = __builtin_amdgcn_permlane32_swap(__float_as_uint(ps), __float_as_uint(ps), false, false);
          ps = __uint_as_float(rr[0]) + __uint_as_float(rr[1]); }
        l_reg = l_reg * alpha + ps;
        bf16x8 pa0, pa1, pa2, pa3;
#define PK4(P, BASE, OUT) do { unsigned a0 = cvtpk(P[BASE + 0], P[BASE + 1]), a1 = cvtpk(P[BASE + 2], P[BASE + 3]);   \
    unsigned b0 = cvtpk(P[BASE + 4], P[BASE + 5]), b1 = cvtpk(P[BASE + 6], P[BASE + 7]);                              \
    auto r0 = __builtin_amdgcn_permlane32_swap(a0, b0, false, false); auto r1 = __builtin_amdgcn_permlane32_swap(a1, b1, false, false); \
    v4u w = {r0[0], r1[0], r0[1], r1[1]}; OUT = __builtin_bit_cast(bf16x8, w); } while (0)
        PK4(p0, 0, pa0); PK4(p0, 8, pa1); PK4(p1, 0, pa2); PK4(p1, 8, pa3);
#undef PK4
        if (__any(alpha < 1.f)) {
            if (hi == 0) al_l[r32] = alpha;
            asm volatile("s_waitcnt lgkmcnt(0)" ::: "memory");
#pragma unroll
            for (int r = 0; r < 16; ++r) { const float al = al_l[crow(r, hi)];
#pragma unroll
                for (int d = 0; d < 4; ++d) o[d][r] *= al; }
        }
        const int vb = vbase + buf * KTILE;
        pv_one<0>(o[0], vb, pa0, pa1, pa2, pa3); pv_one<1>(o[1], vb, pa0, pa1, pa2, pa3);
        pv_one<2>(o[2], vb, pa0, pa1, pa2, pa3); pv_one<3>(o[3], vb, pa0, pa1, pa2, pa3);
        if (j + 1 < NT) AWRITE(buf ^ 1);
        __syncthreads();
    }
    if (hi == 0) al_l[32 + r32] = l_reg;
    asm volatile("s_waitcnt lgkmcnt(0)" ::: "memory");
    bf16* Ow = MIX + (size_t)qrow0 * KMIX + 512 + wid * 128 + r32;
#pragma unroll
    for (int r = 0; r < 16; ++r) { const int orow = crow(r, hi); const float rl = __builtin_amdgcn_rcpf(al_l[32 + orow]);
#pragma unroll
        for (int d0 = 0; d0 < 4; ++d0) Ow[(size_t)orow * KMIX + d0 * 32] = (bf16)f2bf(o[d0][r] * rl); }
    __syncthreads();
#undef ALOAD
#undef AWRITE
}

constexpr int LRU_WB = 14080;
__device__ __forceinline__ float sigmoidf_(float z) { return __builtin_amdgcn_rcpf(1.f + __builtin_amdgcn_exp2f(-1.4426950408889634f * z)); }
__device__ __forceinline__ float gelu_tanh(float x) { const float u = 0.7978845608028654f * (x + 0.044715f * x * x * x); return x * sigmoidf_(2.f * u); }

struct LruTile { float a[2][16], bx[2][16]; };

__device__ __forceinline__ void lru_item(const Args& args, int pm, char* lds, gu32* ctl) {
    const int tid = fresh_tid(), lane = tid & 63, r32 = lane & 31, hi = lane >> 5;
    const int wid = __builtin_amdgcn_readfirstlane(tid >> 6);
    const bf16* PROJ = (const bf16*)(args.ws + WS_PROJ);
    bf16* MIX = (bf16*)(args.ws + WS_MIX);
    float* AGG = (float*)(args.ws + WS_AGG);
    const bool sample = pm >= MP / 256;
    char* wl = lds + wid * LRU_WB;
    float* XC = (float*)wl; bf16* XCB = (bf16*)(wl + 8192); float* CW = (float*)(wl + 8192 + 4608);
    const int ch0 = wid * 64;
    for (int i = lane; i < 320; i += 64) { const int k = i >> 6, c = i & 63; CW[i] = (k < 4) ? args.in[11][k * LRU_W + ch0 + c] : args.in[12][ch0 + c]; }
    bf16x8 wb[2][4][2];
#pragma unroll
    for (int g = 0; g < 2; ++g) { const float* W = (g == 0 ? args.in[13] : args.in[15]) + (size_t)wid * 4096;
#pragma unroll
        for (int s = 0; s < 4; ++s)
#pragma unroll
            for (int cb = 0; cb < 2; ++cb) { float v[8];
#pragma unroll
                for (int j = 0; j < 8; ++j) v[j] = W[(16 * s + 8 * hi + j) * 64 + 32 * cb + r32];
                v4u o; o.x = cvtpk(v[0], v[1]); o.y = cvtpk(v[2], v[3]); o.z = cvtpk(v[4], v[5]); o.w = cvtpk(v[6], v[7]);
                wb[g][s][cb] = __builtin_bit_cast(bf16x8, o); } }
    float ba[2], bi[2], sp[2];
#pragma unroll
    for (int cb = 0; cb < 2; ++cb) { const int c = ch0 + 32 * cb + r32; ba[cb] = args.in[14][c]; bi[cb] = args.in[16][c];
        const float lam = args.in[17][c]; sp[cb] = -8.f * 1.4426950408889634f * log1pf(expf(-lam)); }
    LDS_WAIT();
    const int row0 = pm * 256;
    float h[2] = {0.f, 0.f};
    const int seqb = sample ? 0 : pm / 16, kp = sample ? 0 : pm % 16;
    for (int pass = sample ? 1 : 0; pass < 2; ++pass) {
        float Ap[2] = {1.f, 1.f}, Bp[2] = {0.f, 0.f};
        if (pass == 1 && !sample) {
            h[0] = 0.f; h[1] = 0.f;
            for (int q = 0; q < kp; ++q) {
                const int pq = seqb * 16 + q;
                if (lane == 0) { unsigned sp_ = 0; while (__hip_atomic_load(ctl + CW_AGGF + 64 * pq, RLX_AGENT) == 0u) { __builtin_amdgcn_s_sleep(2); if (++sp_ > (1u << 22)) { __hip_atomic_store(ctl + CW_TMO, 1u, RLX_AGENT); break; } } }
                __builtin_amdgcn_fence(__ATOMIC_ACQUIRE, "agent");
#pragma unroll
                for (int cb = 0; cb < 2; ++cb) { const int c = ch0 + 32 * cb + r32;
                    const float A_ = __hip_atomic_load(AGG + (size_t)pq * 1024 + c, RLX_AGENT), B_ = __hip_atomic_load(AGG + (size_t)pq * 1024 + 512 + c, RLX_AGENT);
                    h[cb] = A_ * h[cb] + B_; }
            }
        }
        for (int tile = 0; tile < 8; ++tile) {
            const int trow0 = row0 + tile * 32;
            int sb = 0;
            if (sample) { sb = (pm - MP / 256) * 8 + tile; if (pass == 1) { h[0] = args.in[4][sb * LRU_W + ch0 + r32]; h[1] = args.in[4][sb * LRU_W + ch0 + 32 + r32]; } }
            const bool seq_start = sample || (kp == 0 && tile == 0);
#pragma unroll
            for (int i = 0; i < 4; ++i) {
                const int chunk = lane + 64 * i, rr = chunk >> 3, cc = chunk & 7;
                float acc[8];
#pragma unroll
                for (int e = 0; e < 8; ++e) acc[e] = CW[256 + 8 * cc + e];
#pragma unroll
                for (int k = 0; k < 4; ++k) {
                    const int t = rr - 3 + k;
                    float xv[8];
                    if (t >= 0 || !seq_start) {
                        const v4u w = *(const v4u*)(PROJ + (size_t)(trow0 + t) * INP + ch0 + 8 * cc);
                        xv[0] = bflo(w.x); xv[1] = bfhi(w.x); xv[2] = bflo(w.y); xv[3] = bfhi(w.y); xv[4] = bflo(w.z); xv[5] = bfhi(w.z); xv[6] = bflo(w.w); xv[7] = bfhi(w.w);
                    } else if (sample) {
                        const float* sp_ = args.in[5] + ((size_t)sb * 3 + (t + 3)) * LRU_W + ch0 + 8 * cc;
                        const f32x4 u0 = *(const f32x4*)sp_, u1 = *(const f32x4*)(sp_ + 4);
                        xv[0] = u0[0]; xv[1] = u0[1]; xv[2] = u0[2]; xv[3] = u0[3]; xv[4] = u1[0]; xv[5] = u1[1]; xv[6] = u1[2]; xv[7] = u1[3];
                    } else {
#pragma unroll
                        for (int e = 0; e < 8; ++e) xv[e] = 0.f;
                    }
#pragma unroll
                    for (int e = 0; e < 8; ++e) acc[e] += CW[k * 64 + 8 * cc + e] * xv[e];
                }
                *(f32x4*)(XC + rr * 64 + 8 * cc) = (f32x4){acc[0], acc[1], acc[2], acc[3]};
                *(f32x4*)(XC + rr * 64 + 8 * cc + 4) = (f32x4){acc[4], acc[5], acc[6], acc[7]};
                v4u o; o.x = cvtpk(acc[0], acc[1]); o.y = cvtpk(acc[2], acc[3]); o.z = cvtpk(acc[4], acc[5]); o.w = cvtpk(acc[6], acc[7]);
                *(v4u*)(XCB + rr * 72 + 8 * cc) = o;
            }
            LDS_WAIT(); asm volatile("" ::: "memory");
#define LRU_CB(cb) do { \
            f32x16 ga = {}, gi = {}; \
            _Pragma("unroll") for (int s = 0; s < 4; ++s) { const bf16x8 af = *(const bf16x8*)(XCB + r32 * 72 + 16 * s + 8 * hi); \
                ga = __builtin_amdgcn_mfma_f32_32x32x16_bf16(af, wb[0][s][cb], ga, 0, 0, 0); gi = __builtin_amdgcn_mfma_f32_32x32x16_bf16(af, wb[1][s][cb], gi, 0, 0, 0); } \
            float av[16], bv[16]; \
            _Pragma("unroll") for (int r = 0; r < 16; ++r) { const float xcv = XC[crow(r, hi) * 64 + 32 * cb + r32]; \
                const float rg = sigmoidf_(ga[r] + ba[cb]), ig = sigmoidf_(gi[r] + bi[cb]); \
                const float a_ = __builtin_amdgcn_exp2f(sp[cb] * rg); \
                av[r] = a_; bv[r] = __builtin_sqrtf(fmaxf(1.f - a_ * a_, 0.f)) * ig * xcv; } \
            float Al[4], Bl[4], Ah[4], Bh[4]; \
            _Pragma("unroll") for (int g = 0; g < 4; ++g) { float A_ = 1.f, B_ = 0.f; \
                _Pragma("unroll") for (int e = 0; e < 4; ++e) { A_ *= av[4 * g + e]; B_ = av[4 * g + e] * B_ + bv[4 * g + e]; } \
                const float Ao = __shfl_xor(A_, 32), Bo = __shfl_xor(B_, 32); \
                Al[g] = hi ? Ao : A_; Bl[g] = hi ? Bo : B_; Ah[g] = hi ? A_ : Ao; Bh[g] = hi ? B_ : Bo; } \
            if (pass == 0) { \
                _Pragma("unroll") for (int g = 0; g < 4; ++g) { Bp[cb] = Al[g] * Bp[cb] + Bl[g]; Ap[cb] *= Al[g]; Bp[cb] = Ah[g] * Bp[cb] + Bh[g]; Ap[cb] *= Ah[g]; } \
            } else { \
                float hc = h[cb]; \
                _Pragma("unroll") for (int g = 0; g < 4; ++g) { \
                    const float h_lo_out = Al[g] * hc + Bl[g]; \
                    float hr = hi ? h_lo_out : hc; \
                    _Pragma("unroll") for (int e = 0; e < 4; ++e) { const int r = 4 * g + e; hr = av[r] * hr + bv[r]; \
                        const int row = trow0 + crow(r, hi); \
                        const float gt = bf2f(PROJ[(size_t)row * INP + 512 + ch0 + 32 * cb + r32]); \
                        MIX[(size_t)row * KMIX + ch0 + 32 * cb + r32] = (bf16)f2bf(hr * gelu_tanh(gt)); } \
                    hc = Ah[g] * h_lo_out + Bh[g]; } \
                h[cb] = hc; } \
            } while (0)
            LRU_CB(0); SBAR(); asm volatile("" ::: "memory");
            LRU_CB(1); SBAR();
#undef LRU_CB
            if (pass == 1 && sample) {
                if (hi == 0) { args.out[O_HS + (size_t)sb * LRU_W + ch0 + r32] = h[0]; args.out[O_HS + (size_t)sb * LRU_W + ch0 + 32 + r32] = h[1]; }
            }
            asm volatile("" ::: "memory");
        }
        if (pass == 0) {
#pragma unroll
            for (int cb = 0; cb < 2; ++cb) if (hi == 0) { const int c = ch0 + 32 * cb + r32;
                __hip_atomic_store(AGG + (size_t)pm * 1024 + c, Ap[cb], RLX_AGENT); __hip_atomic_store(AGG + (size_t)pm * 1024 + 512 + c, Bp[cb], RLX_AGENT); }
            asm volatile("s_waitcnt vmcnt(0)" ::: "memory");
            __syncthreads();
            if (tid == 0) __hip_atomic_store(ctl + CW_AGGF + 64 * pm, 1u, RLX_AGENT);
        } else if (!sample && kp == 15) {
            if (hi == 0) { args.out[O_HP + (size_t)seqb * LRU_W + ch0 + r32] = h[0]; args.out[O_HP + (size_t)seqb * LRU_W + ch0 + 32 + r32] = h[1]; }
        }
    }
    __syncthreads();
}

__global__ void __launch_bounds__(NWAVES * 64, 2) hymba_fwd(Args args) {
    extern __shared__ __attribute__((aligned(16))) unsigned char lds[];
    LAS unsigned char* ldsl = (LAS unsigned char*)lds;
    volatile LAS unsigned* MISC = (volatile LAS unsigned*)(ldsl + MISC_OFF);
    const int tid = threadIdx.x, lane = tid & 63, wave = __builtin_amdgcn_readfirstlane(tid >> 6);
    const int G = gridDim.x; const int bx = blockIdx.x; const int vcu = (G % 8 == 0) ? (bx % 8) * (G / 8) + bx / 8 : bx;
    unsigned char* ws = args.ws;
    gu32* ctl = (gu32*)(ws + WS_CTL);
    for (int u = tid; u < (LDS_BYTES - LDSCTL_OFF) / 4; u += NWAVES * 64) ((LAS unsigned*)(ldsl + LDSCTL_OFF))[u] = 0u;
    __syncthreads();
    XcdBarrier bar = xcd_barrier_post((unsigned*)(ctl + CW_BAR), MISC + 8);
    const int gw = vcu * NWAVES + wave, NGW = G * NWAVES;
    const int gt = vcu * (NWAVES * 64) + tid, NGT = G * NWAVES * 64;

    bf16* W1t = (bf16*)(ws + WS_W1); bf16* Wqt = (bf16*)(ws + WS_WQ); bf16* Wot = (bf16*)(ws + WS_WO); bf16* Wupt = (bf16*)(ws + WS_WUP); bf16* Wdnt = (bf16*)(ws + WS_WDN);
    float* ROPET = (float*)(ws + WS_ROPE); float* RSTDQ = (float*)(ws + WS_RSTDQ);
    bf16* XN = (bf16*)(ws + WS_XN); bf16* QRAW = (bf16*)(ws + WS_XN); bf16* PROJ = (bf16*)(ws + WS_PROJ); bf16* KVP = (bf16*)(ws + WS_KVP); bf16* KVS = (bf16*)(ws + WS_KVS);
    bf16* MIX = (bf16*)(ws + WS_MIX); bf16* XN2 = (bf16*)(ws + WS_XN2); bf16* FFB = (bf16*)(ws + WS_XN2); bf16* HID = (bf16*)(ws + WS_HID);
    float* OUT = args.out;

    {
        LAS float* scr = (LAS float*)(ldsl + wave * 16384);
        constexpr int I_1 = (D / 64) * (INC / 32), I_O = (512 / 64) * (D / 32), I_UP = (D / 64) * (FF / 32), I_DN = (FF / 64) * (D / 32);
        constexpr int NITEMS = I_1 + I_O + I_UP + I_DN;
        for (int it = gw; it < NITEMS; it += NGW) {
            int r = it;
            if (r < I_1) { p0_transpose_item(args.in[10], D, INC, INC, W1t, 0, args.in[6], scr, r, lane); continue; } r -= I_1;
            if (r < I_UP) { p0_transpose_item(args.in[23], D, FF, FF, Wupt, 0, args.in[8], scr, r, lane); continue; } r -= I_UP;
            if (r < I_DN) { p0_transpose_item(args.in[24], FF, D, D, Wdnt, 0, nullptr, scr, r, lane); continue; } r -= I_DN;
            {
                const int nblk = D / 32, kb = r / nblk, nb = r % nblk, k0 = 64 * kb, n0 = 32 * nb;
                const float* W = args.in[22];
#pragma unroll 8
                for (int i = 0; i < 32; ++i) { const int kk = 2 * i + (lane >> 5); scr[kk * 33 + (lane & 31)] = W[(size_t)(k0 + kk) * D + n0 + (lane & 31)]; }
                LDS_WAIT(); asm volatile("" ::: "memory");
                const int c = lane & 7;
#pragma unroll
                for (int j = 0; j < 4; ++j) { const int n = (lane >> 3) + 8 * j; const LAS float* s = scr + (8 * c) * 33 + n;
                    v4u o; o.x = pk2(s[0 * 33], s[1 * 33]); o.y = pk2(s[2 * 33], s[3 * 33]); o.z = pk2(s[4 * 33], s[5 * 33]); o.w = pk2(s[6 * 33], s[7 * 33]);
                    *(GAS v4u*)(Wot + (size_t)(n0 + n) * KMIX + k0 + 8 * c) = o; }
                LDS_WAIT(); asm volatile("" ::: "memory");
            }
        }
        for (int i = gt; i < (INP - INC) * D / 8; i += NGT) *(v4u*)(W1t + (size_t)INC * D + (size_t)i * 8) = (v4u){0u, 0u, 0u, 0u};
        for (int i = gt; i < QN * (QL / 8); i += NGT) {
            const int n = i / (QL / 8), r0 = (i % (QL / 8)) * 8;
            float acc[8];
            if (n < 1024) {
                const int hh = n >> 7, c = n & 127; const float* uk = args.in[21] + (size_t)c * 1024 + hh * 128;
#pragma unroll
                for (int e = 0; e < 8; ++e) acc[e] = 0.f;
                for (int e4 = 0; e4 < 16; ++e4) { const f32x4 kv4 = *(const f32x4*)(uk + 4 * e4);
#pragma unroll
                    for (int j = 0; j < 8; ++j) { const f32x4 q4 = *(const f32x4*)(args.in[19] + (size_t)(r0 + j) * 768 + hh * 96 + 4 * e4);
                        acc[j] += q4[0] * kv4[0] + q4[1] * kv4[1] + q4[2] * kv4[2] + q4[3] * kv4[3]; } }
            } else {
                const int jn = n - 1024, hh = jn >> 5, e = 64 + (jn & 31);
#pragma unroll
                for (int j = 0; j < 8; ++j) acc[j] = args.in[19][(size_t)(r0 + j) * 768 + hh * 96 + e];
            }
#pragma unroll
            for (int j = 0; j < 8; ++j) acc[j] *= args.in[18][r0 + j] * QSCALE;
            v4u o; o.x = pk2(acc[0], acc[1]); o.y = pk2(acc[2], acc[3]); o.z = pk2(acc[4], acc[5]); o.w = pk2(acc[6], acc[7]);
            *(v4u*)(Wqt + (size_t)n * QL + r0) = o;
        }
        for (int i = gt; i < NH * 16 * D; i += NGT) {
            const int n = i % D, r8 = (i / D) % 16, hh = i / (D * 16), r0 = r8 * 8;
            float acc[8];
#pragma unroll
            for (int e = 0; e < 8; ++e) acc[e] = 0.f;
            for (int v = 0; v < 64; ++v) { const float wo = args.in[22][(size_t)(512 + hh * 64 + v) * D + n];
#pragma unroll
                for (int j = 0; j < 8; ++j) acc[j] += args.in[21][(size_t)(r0 + j) * 1024 + hh * 128 + 64 + v] * wo; }
            v4u o; o.x = pk2(acc[0], acc[1]); o.y = pk2(acc[2], acc[3]); o.z = pk2(acc[4], acc[5]); o.w = pk2(acc[6], acc[7]);
            *(v4u*)(Wot + (size_t)n * KMIX + 512 + hh * 128 + r0) = o;
        }
        for (int i = gt; i < SKV * 16; i += NGT) {
            const int pos = i >> 4, j = i & 15;
            const float inv = powf(10000.f, -(float)j / 16.f);
            const float ang = (float)pos * inv;
            double t = (double)ang * 0.15915494309189535; t -= floor(t);
            const float fr = (float)t;
            ROPET[pos * 32 + j] = __builtin_amdgcn_cosf(fr); ROPET[pos * 32 + 16 + j] = __builtin_amdgcn_sinf(fr);
        }
        for (int m = gw; m < M; m += NGW) {
            const GAS f32x4* xr = (const GAS f32x4*)xrow_ptr(args, m) + lane;
            f32x4 v[4]; float s2 = 0.f;
#pragma unroll
            for (int j = 0; j < 4; ++j) { v[j] = xr[64 * j]; s2 += (v[j].x * v[j].x + v[j].y * v[j].y) + (v[j].z * v[j].z + v[j].w * v[j].w); }
            const float rstd = 1.f / sqrtf(wave_sum(s2) * (1.f / D) + EPS);
            GAS unsigned long long* o8 = (GAS unsigned long long*)(XN + (size_t)m * D) + lane;
#pragma unroll
            for (int j = 0; j < 4; ++j) o8[64 * j] = (unsigned long long)pk2(v[j].x * rstd, v[j].y * rstd) | ((unsigned long long)pk2(v[j].z * rstd, v[j].w * rstd) << 32);
        }
        for (int i = gt; i < DB * SKVP * 20; i += NGT) {
            const int ch = i % 20, rowi = i / 20, t = rowi % SKVP, b = rowi / SKVP;
            v4u o = (v4u){0u, 0u, 0u, 0u};
            if (t < PAST) {
                const float* src = (ch < 16) ? args.in[2] + ((size_t)b * PAST + t) * KVL + ch * 8 : args.in[3] + ((size_t)b * PAST + t) * ROPE + (ch - 16) * 8;
                const f32x4 u0 = *(const f32x4*)src, u1 = *(const f32x4*)(src + 4);
                o.x = pk2(u0[0], u0[1]); o.y = pk2(u0[2], u0[3]); o.z = pk2(u1[0], u1[1]); o.w = pk2(u1[2], u1[3]);
            } else if (t < SKV) continue;
            *(v4u*)(KVS + (size_t)rowi * KVD + ch * 8) = o;
        }
    }
    xcd_barrier(bar);

    {
        pg8::Gemm g{XN, W1t, M, INP, D, D}; pg8::StaticOrder S; S.init(M, INP, G, bx);
        pg8::EpiBf16<0> E{PROJ, INP};
        pg8::gemm_phase<pg8::EpiBf16<0>, pg8::StaticOrder, true, true>(ldsl, g, S, E);
    }
    xcd_barrier(bar);

    {
        pg8::Gemm g{PROJ + 1024, Wqt, M, QN, QL, INP}; pg8::StaticOrder S; S.init(M, QN, G, bx);
        pg8::EpiBf16<0> E{QRAW, QN};
        pg8::gemm_phase<pg8::EpiBf16<0>, pg8::StaticOrder, true, true>(ldsl, g, S, E);
        for (int m = gw; m < M; m += NGW) {
            const bf16* pr = PROJ + (size_t)m * INP;
            const v2u cq = *(const v2u*)(pr + 1024 + 4 * lane);
            const float q0 = bflo(cq.x), q1 = bfhi(cq.x), q2 = bflo(cq.y), q3 = bfhi(cq.y);
            const float sq = wave_sum(q0 * q0 + q1 * q1 + q2 * q2 + q3 * q3);
            const unsigned ck = *(const unsigned*)(pr + 1280 + 2 * lane);
            const float k0 = bflo(ck), k1 = bfhi(ck);
            const float sk = wave_sum(k0 * k0 + k1 * k1);
            const float rq = 1.f / sqrtf(sq * (1.f / QL) + EPS), rk = 1.f / sqrtf(sk * (1.f / KVL) + EPS);
            if (lane == 0) RSTDQ[m] = rq;
            const float n0 = k0 * rk * args.in[20][2 * lane], n1 = k1 * rk * args.in[20][2 * lane + 1];
            int pos; float* ockv; float* okr; bf16* kvrow;
            if (m < MP) { pos = m % SEQ; ockv = OUT + O_CKVP + (size_t)m * KVL; okr = OUT + O_KRP + (size_t)m * ROPE; kvrow = KVP + (size_t)m * KVD; }
            else { const int ms = m - MP, b = ms / DS, t = ms % DS; pos = PAST + t; ockv = OUT + O_CKVS + (size_t)ms * KVL; okr = OUT + O_KRS + (size_t)ms * ROPE; kvrow = KVS + ((size_t)b * SKVP + PAST + t) * KVD; }
            *(float2*)(ockv + 2 * lane) = make_float2(n0, n1);
            *(unsigned*)(kvrow + 2 * lane) = pk2(n0, n1);
            const float xa = bf2f(pr[1408 + (lane & 15)]), xb = bf2f(pr[1408 + 16 + (lane & 15)]);
            const float c = ROPET[pos * 32 + (lane & 15)], s = ROPET[pos * 32 + 16 + (lane & 15)];
            const float o1 = xa * c - xb * s, o2 = xb * c + xa * s;
            if (lane < 16) { okr[lane] = o1; okr[16 + lane] = o2; kvrow[128 + lane] = (bf16)f2bf(o1); kvrow[144 + lane] = (bf16)f2bf(o2); }
        }
        for (int i = gt; i < (NB + DB) * 3 * LRU_W; i += NGT) {
            const int c = i % LRU_W, k = (i / LRU_W) % 3, sq_ = i / (3 * LRU_W);
            if (sq_ < NB) OUT[O_CVP + (size_t)(sq_ * 3 + k) * LRU_W + c] = bf2f(PROJ[(size_t)(sq_ * SEQ + SEQ - 3 + k) * INP + c]);
            else { const int b = sq_ - NB; OUT[O_CVS + (size_t)(b * 3 + k) * LRU_W + c] = bf2f(PROJ[(size_t)(MP + b * DS + DS - 3 + k) * INP + c]); }
        }
    }
    xcd_barrier(bar);

    {
        constexpr int N_LRU = M / 256, N_ATT = DB + NB * (SEQ / 32), N_ITEMS = N_LRU + N_ATT;
        for (;;) {
            if (tid == 0) MISC[0] = __hip_atomic_fetch_add(ctl + CW_QUEUE, 1u, RLX_AGENT);
            __syncthreads();
            const int it = (int)MISC[0];
            __syncthreads();
            if (it >= N_ITEMS) break;
            #ifndef NO_LRU
            if (it < N_LRU) { lru_item(args, it, (char*)lds, ctl); continue; }
#endif
            const int a = it - N_LRU;
#ifndef NO_ATT
            if (a < DB) {
                attn_unit(KVS + (size_t)a * SKVP * KVD, (SKV + 63) / 64, true, MP + a * DS, PAST, QRAW, RSTDQ, ROPET, MIX, (char*)lds);
            } else {
                const int i2 = a - DB, j = (SEQ / 32 - 1) - i2 / NB, b = i2 % NB;
                attn_unit(KVP + (size_t)b * SEQ * KVD, j / 2 + 1, false, b * SEQ + j * 32, j * 32, QRAW, RSTDQ, ROPET, MIX, (char*)lds);
            }
#endif
        }
    }
    xcd_barrier(bar);

    {
        pg8::Gemm g{MIX, Wot, M, D, KMIX, KMIX}; pg8::StaticOrder S; S.init(M, D, G, bx);
        pg8::EpiF32 E{OUT + O_Y, D};
        pg8::gemm_phase<pg8::EpiF32, pg8::StaticOrder, true, true>(ldsl, g, S, E);
    }
    xcd_barrier(bar);
    for (int m = gw; m < M; m += NGW) {
        const GAS f32x4* xr = (const GAS f32x4*)xrow_ptr(args, m) + lane;
        GAS f32x4* mr = (GAS f32x4*)(OUT + O_Y + (size_t)m * D) + lane;
        f32x4 v[4]; float s2 = 0.f;
#pragma unroll
        for (int j = 0; j < 4; ++j) { v[j] = mr[64 * j]; s2 += (v[j].x * v[j].x + v[j].y * v[j].y) + (v[j].z * v[j].z + v[j].w * v[j].w); }
        const float rstd = 1.f / sqrtf(wave_sum(s2) * (1.f / D) + EPS);
        float s3 = 0.f;
#pragma unroll
        for (int j = 0; j < 4; ++j) { const f32x4 gq = *((const GAS f32x4*)args.in[7] + lane + 64 * j); const f32x4 xv = xr[64 * j];
            v[j] = xv + v[j] * rstd * gq; mr[64 * j] = v[j]; s3 += (v[j].x * v[j].x + v[j].y * v[j].y) + (v[j].z * v[j].z + v[j].w * v[j].w); }
        const float rstd2 = 1.f / sqrtf(wave_sum(s3) * (1.f / D) + EPS);
        GAS unsigned long long* o8 = (GAS unsigned long long*)(XN2 + (size_t)m * D) + lane;
#pragma unroll
        for (int j = 0; j < 4; ++j) o8[64 * j] = (unsigned long long)pk2(v[j].x * rstd2, v[j].y * rstd2) | ((unsigned long long)pk2(v[j].z * rstd2, v[j].w * rstd2) << 32);
    }
    xcd_barrier(bar);

    {
        pg8::Gemm g{XN2, Wupt, M, FF, D, D}; pg8::StaticOrder S; S.init(M, FF, G, bx);
        pg8::EpiBf16<2> E{HID, FF};
        pg8::gemm_phase<pg8::EpiBf16<2>, pg8::StaticOrder, true, true>(ldsl, g, S, E);
    }
    xcd_barrier(bar);
    {
        pg8::Gemm g{HID, Wdnt, M, D, FF, FF}; pg8::StaticOrder S; S.init(M, D, G, bx);
        pg8::EpiBf16<0> E{FFB, D};
        pg8::gemm_phase<pg8::EpiBf16<0>, pg8::StaticOrder, true, true>(ldsl, g, S, E);
    }
    xcd_barrier(bar);
    {
        const unsigned poison = __hip_atomic_load(ctl + CW_TMO, RLX_AGENT) | __hip_atomic_load((gu32*)(ctl + CW_BAR + XB_TMO), RLX_AGENT);
        for (int m = gw; m < M; m += NGW) {
            GAS f32x4* mr = (GAS f32x4*)(OUT + O_Y + (size_t)m * D) + lane;
            const GAS v2u* fr = (const GAS v2u*)(FFB + (size_t)m * D) + lane;
            f32x4 v[4]; float s2 = 0.f;
#pragma unroll
            for (int j = 0; j < 4; ++j) { const v2u w = fr[64 * j]; v[j] = (f32x4){bflo(w.x), bfhi(w.x), bflo(w.y), bfhi(w.y)}; s2 += (v[j].x * v[j].x + v[j].y * v[j].y) + (v[j].z * v[j].z + v[j].w * v[j].w); }
            const float rstd = 1.f / sqrtf(wave_sum(s2) * (1.f / D) + EPS);
#pragma unroll
            for (int j = 0; j < 4; ++j) { const f32x4 gq = *((const GAS f32x4*)args.in[9] + lane + 64 * j); f32x4 o = mr[64 * j] + v[j] * rstd * gq;
                if (poison) o = (f32x4){__builtin_nanf(""), __builtin_nanf(""), __builtin_nanf(""), __builtin_nanf("")};
                mr[64 * j] = o; }
        }
    }
}

extern "C" void kernel_launch(void* const* d_in, const int* in_sizes, int n_in, void* d_out, int out_size, void* d_ws, size_t ws_size, hipStream_t stream) {
    static int grid = 0;
    if (grid == 0) {
        if (n_in != 25 || in_sizes[0] != MP * D || out_size != (int)O_END || ws_size < WS_END) {
            fprintf(stderr, "kernel_launch: shape mismatch n_in %d in0 %d out %d ws %zu\n", n_in, n_in > 0 ? in_sizes[0] : -1, out_size, ws_size); grid = -1; return; }
        int dev = 0, cus = 0;
        if (hipGetDevice(&dev) != hipSuccess || hipDeviceGetAttribute(&cus, hipDeviceAttributeMultiprocessorCount, dev) != hipSuccess) { grid = -1; return; }
        if (hipFuncSetAttribute((const void*)hymba_fwd, hipFuncAttributeMaxDynamicSharedMemorySize, LDS_BYTES) != hipSuccess) { fprintf(stderr, "kernel_launch: hipFuncSetAttribute failed\n"); grid = -1; return; }
        int per_cu = 0;
        (void)hipOccupancyMaxActiveBlocksPerMultiprocessor(&per_cu, (const void*)hymba_fwd, NWAVES * 64, LDS_BYTES);
        (void)hipGetLastError();
        grid = cus;
    }
    if (grid < 0) return;
    if (hipMemsetAsync((char*)d_ws + WS_CTL, 0, CTL_ZERO_BYTES, stream) != hipSuccess) return;
    Args a{};
    for (int i = 0; i < 25; ++i) a.in[i] = (const float*)d_in[i];
    a.out = (float*)d_out; a.ws = (unsigned char*)d_ws;
    hipLaunchKernelGGL(hymba_fwd, dim3(grid), dim3(NWAVES * 64), LDS_BYTES, stream, a);
    const hipError_t le = hipPeekAtLastError();
    if (le != hipSuccess) fprintf(stderr, "kernel_launch: launch failed: %s\n", hipGetErrorName(le));
}
```
